# Optimizing an MI355X kernel written in HIP

```python
import math
import jax, jax.numpy as jnp
from jax import lax
import numpy as np

D_MODEL = 1024
BATCH = 8
SEQ = 2048
DEPTH = 1
DEC_BATCH = 128
DEC_SEQ = 4
PAST_LEN = 16384
PAGE_SIZE = 128

N_DN_HEADS = 8
DN_HEAD_DIM = 64
DN_WIDTH = N_DN_HEADS * DN_HEAD_DIM
CONV_CH = D_MODEL - DN_WIDTH
CONV_GROUPS = 8
CONV_GROUP_DIM = CONV_CH // CONV_GROUPS
SHORT_CONV = 4
DW_CONV = 31
CHUNK = 64
D_FF = 4 * D_MODEL
D_PLE = 256
EPS = 1e-6
IN_COLS = 4 * DN_WIDTH + 2 * N_DN_HEADS + 2 * CONV_CH

kernel_name = 'hybrid_gdn_conformer_decode_step'


def rmsnorm(x, gain):
    xf = x.astype(jnp.float32)
    y = xf * lax.rsqrt(jnp.mean(xf * xf, axis=-1, keepdims=True) + EPS)
    return (y * gain.astype(jnp.float32)).astype(x.dtype)


def l2norm(x):
    xf = x.astype(jnp.float32)
    return xf * lax.rsqrt(jnp.sum(xf * xf, axis=-1, keepdims=True) + EPS)


def causal_depthwise_conv(x_full, w):
    ch = x_full.shape[-1]
    return lax.conv_general_dilated(
        x_full, w[:, None, :].astype(x_full.dtype), window_strides=(1,), padding='VALID',
        dimension_numbers=('NWC', 'WIO', 'NWC'), feature_group_count=ch)


def gated_delta_rule(q, k, v, g, beta, s0):
    b, t, h, dk = q.shape
    dv = v.shape[-1]
    c = min(CHUNK, t)
    n = -(-t // c)
    pad = n * c - t
    f32 = jnp.float32

    def prep(a):
        a = a.astype(f32)
        a = jnp.pad(a, [(0, 0), (0, pad)] + [(0, 0)] * (a.ndim - 2))
        a = a.reshape((b, n, c) + a.shape[2:])
        return jnp.moveaxis(a, 3, 1)

    q, k, v, g, beta = prep(q), prep(k), prep(v), prep(g), prep(beta)
    q = q * (dk ** -0.5)
    gc = jnp.cumsum(g, axis=-1)
    k_beta = k * beta[..., None]
    v_beta = v * beta[..., None]
    idx = jnp.arange(c)
    causal = idx[:, None] >= idx[None, :]
    strict = idx[:, None] > idx[None, :]
    diff = gc[..., :, None] - gc[..., None, :]
    decay = jnp.exp(jnp.where(causal, diff, -jnp.inf))
    lmat = jnp.where(strict, jnp.einsum('bhncd,bhnmd->bhncm', k_beta, k) * decay, 0.0)
    eye = jnp.eye(c, dtype=f32)
    tmat = lax.linalg.triangular_solve(eye + lmat, jnp.broadcast_to(eye, lmat.shape),
                                       left_side=True, lower=True, unit_diagonal=True)
    u = jnp.einsum('bhncm,bhnmd->bhncd', tmat, v_beta)
    w = jnp.einsum('bhncm,bhnmd->bhncd', tmat, k_beta * jnp.exp(gc)[..., None])
    qk = jnp.einsum('bhncd,bhnmd->bhncm', q, k) * decay
    q_dec = q * jnp.exp(gc)[..., None]
    k_dec = k * jnp.exp(gc[..., -1:] - gc)[..., None]
    g_last = jnp.exp(gc[..., -1])

    def step(s, xs):
        u_c, w_c, qk_c, qd_c, kd_c, gl_c = xs
        v_new = u_c - jnp.einsum('bhcd,bhde->bhce', w_c, s)
        o_c = jnp.einsum('bhcd,bhde->bhce', qd_c, s) + jnp.einsum('bhcm,bhme->bhce', qk_c, v_new)
        s = s * gl_c[..., None, None] + jnp.einsum('bhcd,bhce->bhde', kd_c, v_new)
        return s, o_c

    xs = tuple(jnp.moveaxis(a, 2, 0) for a in (u, w, qk, q_dec, k_dec, g_last))
    s_final, o = lax.scan(step, s0.astype(f32), xs)
    o = jnp.transpose(o, (1, 0, 3, 2, 4)).reshape(b, n * c, h, dv)[:, :t]
    return o, s_final


def decoder_layer(x, p_emb, qkv_buf, conf_buf, s0, g_mix, w_in, w_short, a_log, dt_bias, g_o,
                  w_dw, b_dw, g_cln, b_cln, w_out, g_mlp, w_up, w_down, w_ple, g_ple, w_ple_gate):
    f32 = jnp.float32
    bsz, t, _ = x.shape
    h = rmsnorm(x, g_mix)
    proj = h @ w_in
    o0 = 3 * DN_WIDTH
    o1 = o0 + DN_WIDTH
    o2 = o1 + 2 * N_DN_HEADS
    qkv_in = proj[..., :o0]
    z = proj[..., o0:o1]
    b_logit = proj[..., o1:o1 + N_DN_HEADS]
    a_logit = proj[..., o1 + N_DN_HEADS:o2]
    glu_in = proj[..., o2:]

    qkv_full = jnp.concatenate([qkv_buf.astype(x.dtype), qkv_in], axis=1)
    new_qkv_buf = qkv_full[:, -(SHORT_CONV - 1):]
    qkv = jax.nn.silu(causal_depthwise_conv(qkv_full, w_short))
    heads = lambda a: a.reshape(bsz, t, N_DN_HEADS, DN_HEAD_DIM)
    q = l2norm(heads(qkv[..., :DN_WIDTH]))
    k = l2norm(heads(qkv[..., DN_WIDTH:2 * DN_WIDTH]))
    v = heads(qkv[..., 2 * DN_WIDTH:])
    beta = jax.nn.sigmoid(b_logit.astype(f32))
    g = -jnp.exp(a_log.astype(f32)) * jax.nn.softplus(a_logit.astype(f32) + dt_bias.astype(f32))
    o, s_new = gated_delta_rule(q, k, v, g, beta, s0)
    o = rmsnorm(o, g_o) * jax.nn.silu(heads(z).astype(f32))
    o = o.reshape(bsz, t, DN_WIDTH).astype(x.dtype)

    glu = glu_in[..., :CONV_CH] * jax.nn.sigmoid(glu_in[..., CONV_CH:])
    conf_full = jnp.concatenate([conf_buf.astype(x.dtype), glu], axis=1)
    new_conf_buf = conf_full[:, -(DW_CONV - 1):]
    cv = causal_depthwise_conv(conf_full, w_dw) + b_dw.astype(x.dtype)
    cf = cv.astype(f32).reshape(bsz, t, CONV_GROUPS, CONV_GROUP_DIM)
    mu = jnp.mean(cf, axis=-1, keepdims=True)
    var = jnp.mean(jnp.square(cf - mu), axis=-1, keepdims=True)
    cf = ((cf - mu) * lax.rsqrt(var + EPS)).reshape(bsz, t, CONV_CH) * g_cln.astype(f32) + b_cln.astype(f32)
    cv = jax.nn.silu(cf).astype(x.dtype)

    x = x + jnp.concatenate([o, cv], axis=-1) @ w_out

    h = rmsnorm(x, g_mlp)
    x = x + jnp.square(jax.nn.relu(h @ w_up)) @ w_down

    gate = jax.nn.sigmoid(rmsnorm(x, g_ple) @ w_ple_gate)
    x = x + (p_emb.astype(x.dtype) @ w_ple) * gate
    return x, new_qkv_buf, new_conf_buf, s_new.astype(s0.dtype)


def setup_inputs(seed: int = 0) -> dict:
    key = jax.random.key(seed)
    ks = jax.random.split(key, 32)
    f32 = jnp.float32
    nrm = lambda k, shape, scale: jax.random.normal(k, shape, f32) * scale
    gain = lambda k, shape: 1.0 + 0.05 * jax.random.normal(k, shape, f32)
    dt = jnp.exp(jax.random.uniform(ks[20], (DEPTH, N_DN_HEADS), f32, math.log(1e-3), math.log(0.1)))
    dt_bias = dt + jnp.log(-jnp.expm1(-dt))
    a_log = jnp.log(jax.random.uniform(ks[21], (DEPTH, N_DN_HEADS), f32, 1.0, 16.0))
    return {
        'x_prompt': nrm(ks[0], (BATCH, SEQ, D_MODEL), 1.0),
        'x_sample': nrm(ks[1], (DEC_BATCH, DEC_SEQ, D_MODEL), 1.0),
        'state_ssm': nrm(ks[2], (DEPTH, DEC_BATCH, N_DN_HEADS, DN_HEAD_DIM, DN_HEAD_DIM), 0.05),
        'state_qkv_conv': nrm(ks[3], (DEPTH, DEC_BATCH, SHORT_CONV - 1, 3 * DN_WIDTH), 1.0),
        'state_conf_conv': nrm(ks[4], (DEPTH, DEC_BATCH, DW_CONV - 1, CONV_CH), 0.5),
        'p_prompt': nrm(ks[5], (DEPTH, BATCH, SEQ, D_PLE), 1.0),
        'p_sample': nrm(ks[6], (DEPTH, DEC_BATCH, DEC_SEQ, D_PLE), 1.0),
        'g_mix': gain(ks[7], (DEPTH, D_MODEL)),
        'w_in': nrm(ks[8], (DEPTH, D_MODEL, IN_COLS), D_MODEL ** -0.5),
        'w_short': nrm(ks[9], (DEPTH, SHORT_CONV, 3 * DN_WIDTH), SHORT_CONV ** -0.5),
        'a_log': a_log,
        'dt_bias': dt_bias,
        'g_o': gain(ks[10], (DEPTH, DN_HEAD_DIM)),
        'w_dw': nrm(ks[11], (DEPTH, DW_CONV, CONV_CH), DW_CONV ** -0.5),
        'b_dw': nrm(ks[12], (DEPTH, CONV_CH), 0.02),
        'g_cln': gain(ks[13], (DEPTH, CONV_CH)),
        'b_cln': nrm(ks[14], (DEPTH, CONV_CH), 0.02),
        'w_out': nrm(ks[15], (DEPTH, D_MODEL, D_MODEL), D_MODEL ** -0.5),
        'g_mlp': gain(ks[16], (DEPTH, D_MODEL)),
        'w_up': nrm(ks[17], (DEPTH, D_MODEL, D_FF), D_MODEL ** -0.5),
        'w_down': nrm(ks[18], (DEPTH, D_FF, D_MODEL), D_FF ** -0.5),
        'w_ple': nrm(ks[19], (DEPTH, D_PLE, D_MODEL), D_PLE ** -0.5),
        'g_ple': gain(ks[22], (DEPTH, D_MODEL)),
        'w_ple_gate': nrm(ks[23], (DEPTH, D_MODEL, D_MODEL), D_MODEL ** -0.5),
        'g_final': gain(ks[24], (D_MODEL,)),
    }


def reference(x_prompt, x_sample, state_ssm, state_qkv_conv, state_conf_conv, p_prompt, p_sample,
              g_mix, w_in, w_short, a_log, dt_bias, g_o, w_dw, b_dw, g_cln, b_cln, w_out,
              g_mlp, w_up, w_down, w_ple, g_ple, w_ple_gate, g_final):
    bp = x_prompt.shape[0]
    yp, ys = x_prompt, x_sample
    ssm_p, qkv_p, conf_p, ssm_s, qkv_s, conf_s = [], [], [], [], [], []
    for i in range(DEPTH):
        params = (g_mix[i], w_in[i], w_short[i], a_log[i], dt_bias[i], g_o[i], w_dw[i], b_dw[i],
                  g_cln[i], b_cln[i], w_out[i], g_mlp[i], w_up[i], w_down[i], w_ple[i], g_ple[i],
                  w_ple_gate[i])
        zq = jnp.zeros((bp, SHORT_CONV - 1, 3 * DN_WIDTH), x_prompt.dtype)
        zc = jnp.zeros((bp, DW_CONV - 1, CONV_CH), x_prompt.dtype)
        zs = jnp.zeros((bp, N_DN_HEADS, DN_HEAD_DIM, DN_HEAD_DIM), state_ssm.dtype)
        yp, bq, bc, sp = decoder_layer(yp, p_prompt[i], zq, zc, zs, *params)
        ys, sq, sc, ss = decoder_layer(ys, p_sample[i], state_qkv_conv[i], state_conf_conv[i],
                                       state_ssm[i], *params)
        ssm_p.append(sp); qkv_p.append(bq); conf_p.append(bc)
        ssm_s.append(ss); qkv_s.append(sq); conf_s.append(sc)
    y_prompt = rmsnorm(yp, g_final)
    y_sample = rmsnorm(ys, g_final)
    return (y_prompt, y_sample, jnp.stack(ssm_p), jnp.stack(qkv_p), jnp.stack(conf_p),
            jnp.stack(ssm_s), jnp.stack(qkv_s), jnp.stack(conf_s))
```

```cpp
#include <hip/hip_runtime.h>
#include <hip/hip_cooperative_groups.h>
#include <cstdio>
#include <cstdint>
namespace cg = cooperative_groups;

constexpr int D = 1024, MP = 16384, MS = 512, M = MP + MS, FF = 4096, DPLE = 256;
constexpr int SEQ = 2048, NB = 8, NSB = 128, TS = 4, NH = 8, HD = 64, DNW = 512, CCH = 512;
constexpr int INC = 3088, NIN = 3072;
constexpr float EPS = 1e-6f;

namespace pg8 {
#define PG8_LAS __attribute__((address_space(3)))
typedef unsigned short bf16_t;
typedef short bf16x8 __attribute__((ext_vector_type(8)));
typedef float f32x4 __attribute__((ext_vector_type(4)));
typedef unsigned u32x4 __attribute__((ext_vector_type(4)));
constexpr int BM = 256, BK = 64, HALF = 128, HTB = HALF * BK * 2  , STAGE_BYTES = 8 * HTB, NXCD = 8, WGM = 8;

__host__ __device__ __forceinline__ int lds_byte(int r, int c) { const int st = (r >> 4) * 2 + (c >> 5), rr = r & 15, cc = c & 31, ob = rr * 64 + cc * 2; return st * 1024 + (ob ^ (((ob >> 9) & 1) << 5)); }
__host__ __device__ __forceinline__ void stage_rc(int b, int& R, int& C) { const int st = b / 1024, sb = b % 1024, swz = sb ^ (((sb >> 9) & 1) << 5); R = (st >> 1) * 16 + swz / 64; C = (st & 1) * 32 + (swz % 64) / 2; }
__host__ __device__ __forceinline__ int perm32(int rho) { const int n = rho >> 4, i = rho & 15; return 8 * (i >> 2) + 4 * n + (i & 3); }

struct Unit { int pm, pn; };
struct Gemm { const bf16_t* A; const bf16_t* Bt; int M, N, K; };

struct StaticOrder {
    int nM, nN, nwg, G, c;
    __host__ __device__ void init(int M, int N, int G_, int c_) { nM = M / BM; nN = N / BM; nwg = nM * nN; G = G_; c = c_; }
    __host__ __device__ bool next(int i, Unit& u) const {
        const long L = (long)i * G + c; if (L >= nwg) return false;
        int wgid = (int)L; { const int q = nwg / NXCD, r = nwg % NXCD, xcd = wgid % NXCD, off = wgid / NXCD; wgid = (xcd < r ? xcd * (q + 1) : r * (q + 1) + (xcd - r) * q) + off; }
        const int nig = WGM * nN, gid = wgid / nig, fm = gid * WGM, gsz = (nM - fm) < WGM ? (nM - fm) : WGM;
        u.pm = fm + ((wgid % nig) % gsz); u.pn = (wgid % nig) / gsz; return true;
    }
    __device__ __forceinline__ void a_ready(const Unit&) const {}
    __device__ __forceinline__ void done(const Unit&) const {}
};


typedef float f32x2c __attribute__((ext_vector_type(2))); typedef __bf16 bf16x2c __attribute__((ext_vector_type(2)));
__device__ __forceinline__ unsigned cvt_pk_bf16(float lo, float hi) { f32x2c v = {lo, hi}; bf16x2c b = __builtin_convertvector(v, bf16x2c); return __builtin_bit_cast(unsigned, b); }
typedef unsigned u32x2 __attribute__((ext_vector_type(2)));
__device__ __forceinline__ float sigm(float x) { return __builtin_amdgcn_rcpf(1.0f + __expf(-x)); }
__device__ __forceinline__ float rstd_of(float ss) { return __builtin_amdgcn_rsqf(ss * (1.0f / 1024.0f) + EPS); }

struct EpiIn {
    static constexpr bool PERM = true, AFTER_DRAIN = false;
    bf16_t* qkvz; bf16_t* glu; const float* rowss;
    __device__ __forceinline__ void operator()(const f32x4 (&acc)[2][2][4][2], const Unit& u, int wr, int wc, int fr, int fq) const {
        const int row0 = u.pm * BM + wr * 64 + fr;
        if (u.pn < 8) {
            const int col0 = u.pn * BM + wc * 32 + 8 * fq;
#pragma unroll
            for (int ai = 0; ai < 2; ++ai)
#pragma unroll
                for (int m = 0; m < 4; ++m) { const int row = row0 + ai * HALF + m * 16; const float rs = rstd_of(rowss[row]); bf16_t* rowp = qkvz + (size_t)row * 2048 + col0;
#pragma unroll
                    for (int bj = 0; bj < 2; ++bj) { const f32x4 v0 = acc[ai][bj][m][0] * rs, v1 = acc[ai][bj][m][1] * rs;
                        u32x4 w; w.x = cvt_pk_bf16(v0[0], v0[1]); w.y = cvt_pk_bf16(v0[2], v0[3]); w.z = cvt_pk_bf16(v1[0], v1[1]); w.w = cvt_pk_bf16(v1[2], v1[3]);
                        *(u32x4*)(rowp + bj * HALF) = w; }
                    asm volatile("" ::: "memory"); }
        } else {
            const int col0 = (u.pn - 8) * 128 + wc * 32 + 8 * fq;
#pragma unroll
            for (int ai = 0; ai < 2; ++ai)
#pragma unroll
                for (int m = 0; m < 4; ++m) { const int row = row0 + ai * HALF + m * 16; const float rs = rstd_of(rowss[row]);
                    float g[8];
#pragma unroll
                    for (int n = 0; n < 2; ++n)
#pragma unroll
                        for (int i = 0; i < 4; ++i) g[n * 4 + i] = (acc[ai][0][m][n][i] * rs) * sigm(acc[ai][1][m][n][i] * rs);
                    u32x4 w; w.x = cvt_pk_bf16(g[0], g[1]); w.y = cvt_pk_bf16(g[2], g[3]); w.z = cvt_pk_bf16(g[4], g[5]); w.w = cvt_pk_bf16(g[6], g[7]);
                    *(u32x4*)(glu + (size_t)row * 512 + col0) = w; asm volatile("" ::: "memory"); }
        }
    }
};

template <int ACT  > struct EpiBf {
    static constexpr bool PERM = true, AFTER_DRAIN = false;
    bf16_t* O; int ldc; const float* rowss;
    __device__ __forceinline__ void operator()(const f32x4 (&acc)[2][2][4][2], const Unit& u, int wr, int wc, int fr, int fq) const {
        const int row0 = u.pm * BM + wr * 64 + fr, col0 = u.pn * BM + wc * 32 + 8 * fq;
#pragma unroll
        for (int ai = 0; ai < 2; ++ai)
#pragma unroll
            for (int m = 0; m < 4; ++m) { const int row = row0 + ai * HALF + m * 16; float rs = 1.f; if (ACT == 1) rs = rstd_of(rowss[row]); bf16_t* rowp = O + (size_t)row * ldc + col0;
#pragma unroll
                for (int bj = 0; bj < 2; ++bj) { f32x4 v0 = acc[ai][bj][m][0], v1 = acc[ai][bj][m][1];
                    if (ACT == 1) {
#pragma unroll
                        for (int i = 0; i < 4; ++i) { const float a = fmaxf(v0[i] * rs, 0.f), b = fmaxf(v1[i] * rs, 0.f); v0[i] = a * a; v1[i] = b * b; } }
                    u32x4 w; w.x = cvt_pk_bf16(v0[0], v0[1]); w.y = cvt_pk_bf16(v0[2], v0[3]); w.z = cvt_pk_bf16(v1[0], v1[1]); w.w = cvt_pk_bf16(v1[2], v1[3]);
                    *(u32x4*)(rowp + bj * HALF) = w; }
                asm volatile("" ::: "memory"); }
    }
};

template <int MODE> struct EpiRes {
    static constexpr bool PERM = false, AFTER_DRAIN = false;
    const float* xp; const float* xs; float* Y; bf16_t* Yb; float* ss_out; const float* ss_in; const bf16_t* ple;
    __device__ __forceinline__ void operator()(const f32x4 (&acc)[2][2][4][2], const Unit& u, int wr, int wc, int fr, int fq) const {
        const int row0 = u.pm * BM + wr * 64 + fr, col0 = u.pn * BM + wc * 32 + 4 * fq;
#pragma unroll
        for (int ai = 0; ai < 2; ++ai)
#pragma unroll
            for (int m = 0; m < 4; ++m) { const int row = row0 + ai * HALF + m * 16; const size_t off = (size_t)row * D + col0;
                const float* src = (MODE == 0) ? (row < MP ? xp + off : xs + (off - (size_t)MP * D)) : (const float*)(Y + off);
                float rs = 1.f; if (MODE == 2) rs = rstd_of(ss_in[row]);
                float s = 0.f;
#pragma unroll
                for (int bj = 0; bj < 2; ++bj)
#pragma unroll
                    for (int n = 0; n < 2; ++n) { const int co = bj * HALF + n * 16; const f32x4 bs = *(const f32x4*)(src + co); f32x4 o;
                        if (MODE == 2) { const u32x2 pw = *(const u32x2*)(ple + off + co);
                            const float p0 = __uint_as_float(pw.x << 16), p1 = __uint_as_float(pw.x & 0xffff0000u), p2 = __uint_as_float(pw.y << 16), p3 = __uint_as_float(pw.y & 0xffff0000u);
                            const f32x4 a = acc[ai][bj][m][n] * rs; o[0] = bs[0] + p0 * sigm(a[0]); o[1] = bs[1] + p1 * sigm(a[1]); o[2] = bs[2] + p2 * sigm(a[2]); o[3] = bs[3] + p3 * sigm(a[3]); }
                        else o = bs + acc[ai][bj][m][n];
                        *(f32x4*)(Y + off + co) = o; s += (o[0] * o[0] + o[1] * o[1]) + (o[2] * o[2] + o[3] * o[3]);
                        if (MODE != 2) { u32x2 w; w.x = cvt_pk_bf16(o[0], o[1]); w.y = cvt_pk_bf16(o[2], o[3]); *(u32x2*)(Yb + off + co) = w; } }
                s += __shfl_xor(s, 16); s += __shfl_xor(s, 32);
                if (fq == 0) atomicAdd(ss_out + row, s); }
    }
};
template <class Epi, class Sched, bool ALIGN_EPI = false, bool SP2 = false>
__device__ __forceinline__ void gemm_phase(PG8_LAS unsigned char* lds, const Gemm g, const Sched& S, const Epi& E) {
    int tid_ = threadIdx.x; asm volatile("" : "+v"(tid_));
    const int tid = tid_, wid = __builtin_amdgcn_readfirstlane(tid >> 6), lane = tid & 63, wr = wid >> 2, wc = wid & 3, fr = lane & 15, fq = lane >> 4;
    int K_ = g.K; asm volatile("" : "+s"(K_));
    const int K = K_, nt = K / BK;
    unsigned voffA[2], voffB[2];
#pragma unroll
    for (int i = 0; i < 2; ++i) { int R, C; stage_rc(tid * 16 + i * 8192, R, C); const int Rb = Epi::PERM ? ((R & ~31) + perm32(R & 31)) : R;
        voffA[i] = (unsigned)(R * K + C) * 2u; voffB[i] = (unsigned)(Rb * K + C) * 2u; }
    const size_t kstep = (size_t)(BK * 2);
    const size_t hstep = (size_t)HALF * K * 2;
    const size_t tstep = 2 * hstep;
    const unsigned ldsw = (unsigned)wid * 1024u;
    const int aoff = lds_byte(wr * 64 + fr, fq * 8), boff = lds_byte(wc * 32 + fr, fq * 8);
#define PG8_SA(b, h) (((b) * 2 + (h)) * HTB)
#define PG8_SB(b, h) ((4 + (b) * 2 + (h)) * HTB)
#define PG8_STAGE(bufoff, gbase, voff) do { _Pragma("unroll") for (int _i = 0; _i < 2; ++_i) \
        __builtin_amdgcn_global_load_lds((const unsigned*)((const char*)(gbase) + (voff)[_i]), (PG8_LAS unsigned*)(lds + (bufoff) + ldsw + _i * 8192), 16, 0, 0); } while (0)
#define PG8_LDA(dst, b, h) do { _Pragma("unroll") for (int m = 0; m < 4; ++m) _Pragma("unroll") for (int k = 0; k < 2; ++k) dst[m][k] = *(const PG8_LAS bf16x8*)(lds + PG8_SA(b, h) + aoff + m * 2048 + k * 1024); } while (0)
#define PG8_LDB(dst, b, h) do { _Pragma("unroll") for (int n = 0; n < 2; ++n) _Pragma("unroll") for (int k = 0; k < 2; ++k) dst[n][k] = *(const PG8_LAS bf16x8*)(lds + PG8_SB(b, h) + boff + n * 2048 + k * 1024); } while (0)
#define PG8_MMA(ai, bj, At, Bt) do { __builtin_amdgcn_s_setprio(1); _Pragma("unroll") for (int m = 0; m < 4; ++m) _Pragma("unroll") for (int n = 0; n < 2; ++n) _Pragma("unroll") for (int k = 0; k < 2; ++k) \
        acc[ai][bj][m][n] = __builtin_amdgcn_mfma_f32_16x16x32_bf16(Bt[n][k], At[m][k], acc[ai][bj][m][n], 0, 0, 0); __builtin_amdgcn_s_setprio(0); } while (0)
#define PG8_WAIT_V(n) asm volatile("s_waitcnt vmcnt(" #n ")" ::: "memory")
#define PG8_WAIT_L(n) asm volatile("s_waitcnt lgkmcnt(" #n ")" ::: "memory")
#define PG8_BAR __builtin_amdgcn_s_barrier()
#define PG8_SCHED __builtin_amdgcn_sched_barrier(0)
    Unit cur, nxt; int ui = 0;
    if (!S.next(0, cur)) return;
    f32x4 acc[2][2][4][2];
#pragma unroll
    for (int a = 0; a < 2; ++a)
#pragma unroll
        for (int b = 0; b < 2; ++b)
#pragma unroll
            for (int m = 0; m < 4; ++m)
#pragma unroll
                for (int n = 0; n < 2; ++n) acc[a][b][m][n] = (f32x4){0.f, 0.f, 0.f, 0.f};
    bf16x8 At[4][2], B0[2][2], B1[2][2];
    const char* cA = (const char*)g.A + (size_t)cur.pm * tstep; const char* cB = (const char*)g.Bt + (size_t)cur.pn * tstep;
    S.a_ready(cur);
    if constexpr (SP2) {
        PG8_STAGE(PG8_SB(0, 0), cB, voffB); PG8_STAGE(PG8_SB(0, 1), cB + hstep, voffB); PG8_STAGE(PG8_SA(0, 0), cA, voffA); PG8_STAGE(PG8_SA(0, 1), cA + hstep, voffA);
        if (wr == 1) PG8_BAR;
        PG8_WAIT_V(2); PG8_BAR;
        PG8_STAGE(PG8_SB(1, 0), cB + kstep, voffB); PG8_STAGE(PG8_SA(1, 0), cA + kstep, voffA); PG8_STAGE(PG8_SB(1, 1), cB + hstep + kstep, voffB);
        PG8_WAIT_V(6); PG8_BAR;
    } else {
        PG8_STAGE(PG8_SB(0, 0), cB, voffB); PG8_STAGE(PG8_SA(0, 0), cA, voffA); PG8_STAGE(PG8_SB(0, 1), cB + hstep, voffB); PG8_STAGE(PG8_SA(0, 1), cA + hstep, voffA);
        if (wr == 1) PG8_BAR;
        PG8_WAIT_V(4); PG8_BAR;
        PG8_STAGE(PG8_SB(1, 0), cB + kstep, voffB); PG8_STAGE(PG8_SA(1, 0), cA + kstep, voffA); PG8_STAGE(PG8_SB(1, 1), cB + hstep + kstep, voffB);
        PG8_WAIT_V(6); PG8_BAR;
    }
    for (;;) {
        const bool has_next = S.next(ui + 1, nxt);
        const char* nA = has_next ? (const char*)g.A + (size_t)nxt.pm * tstep : cA; const char* nB = has_next ? (const char*)g.Bt + (size_t)nxt.pn * tstep : cB;
        for (int t = 0; t < nt; t += 2) {
            const bool last = (t == nt - 2);
            const char* a1 = cA + (size_t)(t + 1) * kstep;
            const char* a2 = last ? nA : cA + (size_t)(t + 2) * kstep; const char* b2 = last ? nB : cB + (size_t)(t + 2) * kstep;
            const char* a3 = a2 + kstep; const char* b3 = b2 + kstep;
            if (last && has_next) S.a_ready(nxt);
            if constexpr (SP2) {
            PG8_LDB(B0, 0, 0); PG8_LDB(B1, 0, 1); PG8_SCHED; PG8_LDA(At, 0, 0); PG8_STAGE(PG8_SA(1, 1), a1 + hstep, voffA);
            PG8_WAIT_V(8); PG8_WAIT_L(0); PG8_BAR; PG8_MMA(0, 0, At, B0); PG8_MMA(0, 1, At, B1); PG8_BAR; PG8_SCHED;
            PG8_LDA(At, 0, 1); PG8_STAGE(PG8_SB(0, 0), b2, voffB); PG8_STAGE(PG8_SB(0, 1), b2 + hstep, voffB); PG8_STAGE(PG8_SA(0, 0), a2, voffA);
            PG8_WAIT_V(8); PG8_WAIT_L(0); PG8_BAR; PG8_MMA(1, 0, At, B0); PG8_MMA(1, 1, At, B1); PG8_BAR; PG8_SCHED;
            PG8_LDB(B0, 1, 0); PG8_LDB(B1, 1, 1); PG8_SCHED; PG8_LDA(At, 1, 0); PG8_STAGE(PG8_SA(0, 1), a2 + hstep, voffA);
            PG8_WAIT_V(8); PG8_WAIT_L(0); PG8_BAR; PG8_MMA(0, 0, At, B0); PG8_MMA(0, 1, At, B1); PG8_BAR; PG8_SCHED;
            PG8_LDA(At, 1, 1); PG8_STAGE(PG8_SB(1, 0), b3, voffB); PG8_STAGE(PG8_SB(1, 1), b3 + hstep, voffB); PG8_STAGE(PG8_SA(1, 0), a3, voffA);
            PG8_WAIT_V(8); PG8_WAIT_L(0); PG8_BAR; PG8_MMA(1, 0, At, B0); PG8_MMA(1, 1, At, B1); PG8_BAR; PG8_SCHED;
            } else {
            PG8_LDB(B0, 0, 0); PG8_SCHED; PG8_LDA(At, 0, 0); PG8_STAGE(PG8_SA(1, 1), a1 + hstep, voffA);
            PG8_WAIT_L(8); PG8_BAR; PG8_WAIT_L(0); PG8_MMA(0, 0, At, B0); PG8_BAR; PG8_SCHED;
            PG8_LDB(B1, 0, 1); PG8_STAGE(PG8_SB(0, 0), b2, voffB);
            PG8_BAR; PG8_WAIT_L(0); PG8_MMA(0, 1, At, B1); PG8_BAR;
            PG8_LDA(At, 0, 1); PG8_STAGE(PG8_SA(0, 0), a2, voffA);
            PG8_BAR; PG8_WAIT_L(0); PG8_MMA(1, 0, At, B0); PG8_BAR; PG8_SCHED;
            PG8_STAGE(PG8_SB(0, 1), b2 + hstep, voffB);
            PG8_WAIT_V(6); PG8_BAR; PG8_MMA(1, 1, At, B1); PG8_BAR;
            PG8_LDB(B0, 1, 0); PG8_SCHED; PG8_LDA(At, 1, 0); PG8_STAGE(PG8_SA(0, 1), a2 + hstep, voffA);
            PG8_WAIT_L(8); PG8_BAR; PG8_WAIT_L(0); PG8_MMA(0, 0, At, B0); PG8_BAR; PG8_SCHED;
            PG8_LDB(B1, 1, 1); PG8_STAGE(PG8_SB(1, 0), b3, voffB);
            PG8_BAR; PG8_WAIT_L(0); PG8_MMA(0, 1, At, B1); PG8_BAR;
            PG8_LDA(At, 1, 1); PG8_STAGE(PG8_SA(1, 0), a3, voffA);
            PG8_BAR; PG8_WAIT_L(0); PG8_MMA(1, 0, At, B0); PG8_BAR; PG8_SCHED;
            PG8_STAGE(PG8_SB(1, 1), b3 + hstep, voffB);
            PG8_WAIT_V(6); PG8_BAR; PG8_MMA(1, 1, At, B1); PG8_BAR;
            }
        }
        if constexpr (ALIGN_EPI) { if (wr == 0) PG8_BAR; }
        if constexpr (!Epi::AFTER_DRAIN) { E(acc, cur, wr, wc, fr, fq); S.done(cur); }
        if (!has_next) break;
#pragma unroll
        for (int a = 0; a < 2; ++a)
#pragma unroll
            for (int b = 0; b < 2; ++b)
#pragma unroll
                for (int m = 0; m < 4; ++m)
#pragma unroll
                    for (int n = 0; n < 2; ++n) acc[a][b][m][n] = (f32x4){0.f, 0.f, 0.f, 0.f};
        cur = nxt; cA = nA; cB = nB; ++ui;
        if constexpr (ALIGN_EPI) { if (wr == 1) PG8_BAR; }
    }
    PG8_WAIT_V(0);
    if constexpr (!ALIGN_EPI) { if (wr == 0) PG8_BAR; }
    PG8_BAR;
    if constexpr (Epi::AFTER_DRAIN) { E.fused(acc, cur, wr, wc, fr, fq, lds, wid, lane); S.done(cur); }
#undef PG8_SA
#undef PG8_SB
#undef PG8_STAGE
#undef PG8_LDA
#undef PG8_LDB
#undef PG8_MMA
#undef PG8_WAIT_V
#undef PG8_WAIT_L
#undef PG8_BAR
#undef PG8_SCHED
}
}
#define GAS __attribute__((address_space(1)))
#define LAS __attribute__((address_space(3)))
typedef unsigned short bf16;
typedef unsigned v4u __attribute__((ext_vector_type(4)));
typedef float f32x4 __attribute__((ext_vector_type(4)));
typedef short bf16x8 __attribute__((ext_vector_type(8)));
typedef GAS unsigned gu32;
typedef GAS unsigned long long gu64;
#define RLX_AGENT __ATOMIC_RELAXED, __HIP_MEMORY_SCOPE_AGENT
#define LDS_WAIT() asm volatile("s_waitcnt lgkmcnt(0)" ::: "memory")
#define VM_WAIT() asm volatile("s_waitcnt vmcnt(0)" ::: "memory")
__device__ __forceinline__ unsigned long long rt() { return __builtin_amdgcn_s_memrealtime(); }
__device__ __forceinline__ unsigned f2bf(float f) { unsigned u = __builtin_bit_cast(unsigned, f); return (u + 0x7fffu + ((u >> 16) & 1u)) >> 16; }
__device__ __forceinline__ unsigned pk2(float lo, float hi) { return f2bf(lo) | (f2bf(hi) << 16); }

#define XB_TMO      128
#define XB_XCNT(j)  (256  + 64 * (j))
#define XB_XSUB(j)  (1280 + 64 * (j))
#define XB_XGEN(j)  (2304 + 64 * (j))
#define XB_TOP      3328
#define XB_TOPGEN   3392
#define XCD_BAR_WORDS 3456
#define XB_SPIN_CAP (1u << 18)

__device__ __forceinline__ unsigned xb_ld(unsigned* p)              { return __hip_atomic_load(p, __ATOMIC_RELAXED, __HIP_MEMORY_SCOPE_AGENT); }
__device__ __forceinline__ unsigned xb_add(unsigned* p, unsigned v) { return __hip_atomic_fetch_add(p, v, __ATOMIC_RELAXED, __HIP_MEMORY_SCOPE_AGENT); }
__device__ __forceinline__ unsigned xb_xcc_id() { return (unsigned)__builtin_amdgcn_s_getreg((3 << 11) | 20) & 0xFu; }
#define XB_SPIN(cond, bar) do { unsigned _sp = 0; while (cond) { __builtin_amdgcn_s_sleep(1); \
    if ((++_sp & 255u) == 0u) { if (xb_ld(&(bar)[XB_TMO])) break; if (_sp > XB_SPIN_CAP) { atomicAdd(&(bar)[XB_TMO], 1u); break; } } } } while (0)

struct XcdBarrier {
    unsigned* bar; unsigned x;
    volatile LAS unsigned* st;
};

__device__ __forceinline__ XcdBarrier xcd_barrier_post(unsigned* bar, volatile LAS unsigned* st) {
    XcdBarrier b; b.bar = bar; b.x = xb_xcc_id(); b.st = st;
    if (threadIdx.x == 0) (void)xb_add(&bar[XB_XCNT(b.x)], 1u);
    return b;
}
__device__ __forceinline__ void xcd_barrier_complete(unsigned* bar, unsigned x, unsigned& nloc, unsigned& nx) {
    const unsigned G = gridDim.x * gridDim.y * gridDim.z;
    unsigned sum, cnt, mine, sp = 0u;
    for (;;) {
        sum = 0u; cnt = 0u; mine = 0u;
#pragma unroll
        for (unsigned j = 0; j < 16; ++j) { const unsigned c = xb_ld(&bar[XB_XCNT(j)]); sum += c; cnt += (c > 0u) ? 1u : 0u; mine = (j == x) ? c : mine; }
        if (sum == G) break;
        __builtin_amdgcn_s_sleep(1);
        if ((++sp & 255u) == 0u) { if (xb_ld(&bar[XB_TMO])) break; if (sp > XB_SPIN_CAP) { atomicAdd(&bar[XB_TMO], 1u); break; } }
    }
    nloc = mine > 0u ? mine : 1u; nx = cnt > 0u ? cnt : 1u;
}

__device__ __forceinline__ void xcd_barrier(const XcdBarrier& b) {
    asm volatile("s_waitcnt vmcnt(0)" ::: "memory");
    __syncthreads();
    if (threadIdx.x == 0) {
        unsigned* bar = b.bar;
        __builtin_amdgcn_s_waitcnt(0);
        unsigned nloc = b.st[0], nx = b.st[1];
        if (nloc == 0u) { xcd_barrier_complete(bar, b.x, nloc, nx); b.st[0] = nloc; b.st[1] = nx; }
        const unsigned old = xb_add(&bar[XB_XSUB(b.x)], 1u);
        const unsigned gen = old / nloc;
        if (old + 1u == (gen + 1u) * nloc) {
            __builtin_amdgcn_fence(__ATOMIC_RELEASE, "agent");
            asm volatile("s_waitcnt vmcnt(0)" ::: "memory");
            const unsigned og = xb_add(&bar[XB_TOP], 1u);
            const unsigned tg = og / nx;
            if (og + 1u == (tg + 1u) * nx) xb_add(&bar[XB_TOPGEN], 1u);
            else XB_SPIN(xb_ld(&bar[XB_TOPGEN]) == tg, bar);
            __builtin_amdgcn_fence(__ATOMIC_ACQUIRE, "agent");
            xb_add(&bar[XB_XGEN(b.x)], 1u);
            asm volatile("s_waitcnt vmcnt(0)" ::: "memory");
        } else {
            XB_SPIN(xb_ld(&bar[XB_XGEN(b.x)]) == gen, bar);
            __builtin_amdgcn_fence(__ATOMIC_ACQUIRE, "agent");
            asm volatile("s_waitcnt vmcnt(0)" ::: "memory");
        }
    }
    __syncthreads();
}


constexpr size_t MiB = 1u << 20;
constexpr size_t WS_CTL = 0, CTL_ZERO_BYTES = 1 * MiB;
constexpr size_t WS_RSS0 = 1 * MiB;
constexpr size_t WS_WIN = 2 * MiB, WS_WOUT = 8 * MiB, WS_WUP = 10 * MiB, WS_WDOWN = 18 * MiB, WS_WGATE = 26 * MiB, WS_WPLE = 28 * MiB;
constexpr size_t WS_BETA = 29 * MiB, WS_G = 29 * MiB + 768 * 1024, WS_GL = 30 * MiB + 512 * 1024;
constexpr size_t WS_QKVZ = 32 * MiB;
constexpr size_t WS_GLU = 98 * MiB;
constexpr size_t WS_XB = 115 * MiB;
constexpr size_t WS_REC = 115 * MiB;
constexpr size_t WS_AMIX = 210 * MiB;
constexpr size_t WS_PB = 244 * MiB;
constexpr size_t WS_X1B = 32 * MiB;
constexpr size_t WS_HB = 66 * MiB;
constexpr size_t WS_X2B = 199 * MiB;
constexpr size_t WS_PLE = 32 * MiB;
constexpr size_t WS_END = 253 * MiB;
constexpr int NCH = SEQ / 16;
constexpr int NITEMS_P = NB * NH * NCH, NITEMS = NITEMS_P + NSB * NH;
constexpr int REC_BYTES = 10752;
constexpr int REC_W = 0, REC_QD = 2048, REC_KD = 4096, REC_QK = 6144, REC_U = 6656;
static_assert(WS_REC + (size_t)NITEMS * REC_BYTES <= WS_AMIX && WS_AMIX + (size_t)M * D * 2 <= WS_PB && WS_PB + (size_t)M * DPLE * 2 <= WS_END, "d_ws map");
static_assert(WS_QKVZ + (size_t)M * 2048 * 2 <= WS_GLU && WS_GLU + (size_t)M * 512 * 2 <= WS_XB && WS_HB + (size_t)M * FF * 2 <= WS_X2B && WS_X2B + (size_t)M * D * 2 <= WS_PB, "d_ws map 2");
static_assert(WS_G + (size_t)M * 8 * 4 <= WS_GL && WS_GL + (size_t)NITEMS * 4 <= WS_QKVZ && WS_BETA + (size_t)M * 8 * 4 <= WS_G, "d_ws map 3");
constexpr int CW_BAR = 4096;
constexpr int CW_RSS1 = 32768, CW_RSS2 = CW_RSS1 + M, CW_RSS3 = CW_RSS2 + M;
static_assert((CW_RSS3 + M) * 4 <= (int)CTL_ZERO_BYTES, "CTL words inside the memset region");
constexpr size_t O_Y = 0, O_SSM_P = (size_t)M * D, O_QKV_P = O_SSM_P + (size_t)NB * NH * HD * HD, O_CONF_P = O_QKV_P + (size_t)NB * 3 * 1536,
                 O_SSM_S = O_CONF_P + (size_t)NB * 30 * CCH, O_QKV_S = O_SSM_S + (size_t)NSB * NH * HD * HD, O_CONF_S = O_QKV_S + (size_t)NSB * 3 * 1536, O_END = O_CONF_S + (size_t)NSB * 30 * CCH;
static_assert(O_END == 24473600, "d_out size");
constexpr int RING_OFF = 0, RING_BYTES = 131072;
constexpr int LDSCTL_OFF = RING_BYTES, MISC_OFF = LDSCTL_OFF + 320;
constexpr int LDS_BYTES = 147456;
constexpr int NWAVES = 8;

typedef unsigned u32x4 __attribute__((ext_vector_type(4)));
typedef unsigned u32x2 __attribute__((ext_vector_type(2)));
typedef float f32x2 __attribute__((ext_vector_type(2)));
struct Frame {
    LAS unsigned char* lds;
    int tid, lane, wave, G, bid;
    const float *xp, *xs, *ssm, *qkvst, *confst, *pp, *psm, *g_mix, *w_in, *w_short, *a_log, *dt_bias, *g_o, *w_dw, *b_dw, *g_cln, *b_cln, *w_out, *g_mlp, *w_up, *w_down, *w_ple, *g_ple, *w_gate, *g_final;
    float* out; unsigned char* ws;
};
__device__ __forceinline__ float bf_lo(unsigned w) { return __uint_as_float(w << 16); }
__device__ __forceinline__ float bf_hi(unsigned w) { return __uint_as_float(w & 0xffff0000u); }
__device__ __forceinline__ float siluf(float x) { return x * __builtin_amdgcn_rcpf(1.0f + __expf(-x)); }
typedef __bf16 bf16x2_t __attribute__((ext_vector_type(2)));
__device__ __forceinline__ unsigned cvtpk(float lo, float hi) { f32x2 v = {lo, hi}; bf16x2_t b = __builtin_convertvector(v, bf16x2_t); return __builtin_bit_cast(unsigned, b); }
#define LDS_FENCE() asm volatile("s_waitcnt lgkmcnt(0)" ::: "memory")

__device__ __forceinline__ void p0_transpose_item(const float* W, int ldw, int K, int n0, int k0, bf16* WT, int drow0, const float* gain, LAS float* scr, int lane) {
#pragma unroll 8
    for (int i = 0; i < 32; ++i) { const int kk = 2 * i + (lane >> 5); float v = W[(size_t)(k0 + kk) * ldw + n0 + (lane & 31)]; if (gain) v *= gain[k0 + kk]; scr[kk * 33 + (lane & 31)] = v; }
    LDS_FENCE();
    const int c = lane & 7;
#pragma unroll
    for (int j = 0; j < 4; ++j) { const int n = (lane >> 3) + 8 * j; const LAS float* s = scr + (8 * c) * 33 + n;
        v4u o; o.x = pk2(s[0 * 33], s[1 * 33]); o.y = pk2(s[2 * 33], s[3 * 33]); o.z = pk2(s[4 * 33], s[5 * 33]); o.w = pk2(s[6 * 33], s[7 * 33]);
        *(GAS v4u*)(WT + (size_t)(drow0 + n) * K + k0 + 8 * c) = o; }
    LDS_FENCE();
}
constexpr int P0_SCR_BYTES = 64 * 33 * 4;
constexpr int P0_BF_OFF = 69632;
__device__ __forceinline__ void p0_prologue(Frame& F) {
    LAS float* scr = (LAS float*)(F.lds + RING_OFF + F.wave * P0_SCR_BYTES);
    const int gw = F.bid * NWAVES + F.wave, NGW = F.G * NWAVES;
    constexpr int I_IN = (D / 64) * (NIN / 32), I_OUT = (D / 64) * (D / 32), I_UP = (D / 64) * (FF / 32), I_DN = (FF / 64) * (D / 32), I_GT = I_OUT, I_PL = (DPLE / 64) * (D / 32);
    constexpr int NIT = I_IN + I_OUT + I_UP + I_DN + I_GT + I_PL;
    for (int it = gw; it < NIT; it += NGW) {
        int r = it;
        if (r < I_IN) { const int nb = r % (NIN / 32), kb = r / (NIN / 32); const int r0 = 32 * nb; int n0;
            if (r0 < 2048) n0 = r0; else { const int rr = r0 - 2048; n0 = 2064 + 512 * ((rr >> 7) & 1) + 128 * (rr >> 8) + (rr & 127); }
            p0_transpose_item(F.w_in, INC, D, n0, 64 * kb, (bf16*)(F.ws + WS_WIN), r0, F.g_mix, scr, F.lane); continue; } r -= I_IN;
        if (r < I_OUT) { const int nb = r % (D / 32), kb = r / (D / 32); p0_transpose_item(F.w_out, D, D, 32 * nb, 64 * kb, (bf16*)(F.ws + WS_WOUT), 32 * nb, nullptr, scr, F.lane); continue; } r -= I_OUT;
        if (r < I_UP) { const int nb = r % (FF / 32), kb = r / (FF / 32); p0_transpose_item(F.w_up, FF, D, 32 * nb, 64 * kb, (bf16*)(F.ws + WS_WUP), 32 * nb, F.g_mlp, scr, F.lane); continue; } r -= I_UP;
        if (r < I_DN) { const int nb = r % (D / 32), kb = r / (D / 32); p0_transpose_item(F.w_down, D, FF, 32 * nb, 64 * kb, (bf16*)(F.ws + WS_WDOWN), 32 * nb, nullptr, scr, F.lane); continue; } r -= I_DN;
        if (r < I_GT) { const int nb = r % (D / 32), kb = r / (D / 32); p0_transpose_item(F.w_gate, D, D, 32 * nb, 64 * kb, (bf16*)(F.ws + WS_WGATE), 32 * nb, F.g_ple, scr, F.lane); continue; } r -= I_GT;
        { const int nb = r % (D / 32), kb = r / (D / 32); p0_transpose_item(F.w_ple, D, DPLE, 32 * nb, 64 * kb, (bf16*)(F.ws + WS_WPLE), 32 * nb, nullptr, scr, F.lane); }
    }
    { const int nthr = F.G * NWAVES * 64, t0 = F.bid * (NWAVES * 64) + F.tid;
      for (int i = t0; i < M * DPLE / 8; i += nthr) { const size_t e = (size_t)i * 8; const float* src = e < (size_t)MP * DPLE ? F.pp + e : F.psm + (e - (size_t)MP * DPLE);
          const f32x4 a = *(const f32x4*)src, b = *(const f32x4*)(src + 4); v4u o; o.x = pk2(a[0], a[1]); o.y = pk2(a[2], a[3]); o.z = pk2(b[0], b[1]); o.w = pk2(b[2], b[3]);
          *(GAS v4u*)((bf16*)(F.ws + WS_PB) + e) = o; } }
    LAS f32x4* Bf = (LAS f32x4*)(F.lds + P0_BF_OFF);
    for (int idx = F.tid; idx < 64 * 64; idx += NWAVES * 64) { const int j = idx >> 6, ln = idx & 63, kq = ln >> 4, n = ln & 15; f32x4 v;
#pragma unroll
        for (int i = 0; i < 4; ++i) { const int k = 16 * j + 4 * kq + i; v[i] = F.w_in[(size_t)k * INC + 2048 + n] * F.g_mix[k]; }
        Bf[idx] = v; }
    __syncthreads();
    bf16* XB = (bf16*)(F.ws + WS_XB); float* rss0 = (float*)(F.ws + WS_RSS0); float* betaA = (float*)(F.ws + WS_BETA); float* gA = (float*)(F.ws + WS_G);
    const int r = F.lane & 15, kq = F.lane >> 4;
    for (int grp = gw; grp < M / 16; grp += NGW) {
        const int m = 16 * grp + r; const float* xrow = m < MP ? F.xp + (size_t)m * D : F.xs + (size_t)(m - MP) * D;
        f32x4 acc = {0.f, 0.f, 0.f, 0.f}; float ss = 0.f;
#pragma unroll 4
        for (int j = 0; j < 64; ++j) { const f32x4 v = *(const f32x4*)(xrow + 16 * j + 4 * kq); const f32x4 b = Bf[j * 64 + F.lane];
            ss += (v[0] * v[0] + v[1] * v[1]) + (v[2] * v[2] + v[3] * v[3]);
            u32x2 w; w.x = pk2(v[0], v[1]); w.y = pk2(v[2], v[3]); *(GAS u32x2*)(XB + (size_t)m * D + 16 * j + 4 * kq) = w;
            acc = __builtin_amdgcn_mfma_f32_16x16x4f32(v[0], b[0], acc, 0, 0, 0); acc = __builtin_amdgcn_mfma_f32_16x16x4f32(v[1], b[1], acc, 0, 0, 0);
            acc = __builtin_amdgcn_mfma_f32_16x16x4f32(v[2], b[2], acc, 0, 0, 0); acc = __builtin_amdgcn_mfma_f32_16x16x4f32(v[3], b[3], acc, 0, 0, 0); }
        ss += __shfl_xor(ss, 16); ss += __shfl_xor(ss, 32);
        if (kq == 0) rss0[m] = ss;
        const float rs = __builtin_amdgcn_rsqf(ss * (1.0f / D) + EPS);
        const int n = F.lane & 15;
#pragma unroll
        for (int reg = 0; reg < 4; ++reg) { const int rr = 4 * kq + reg; const float rsr = __shfl(rs, rr); const float lg = acc[reg] * rsr; const int mm = 16 * grp + rr;
            if (n < 8) betaA[(size_t)mm * 8 + n] = 1.0f / (1.0f + expf(-lg));
            else { const float xx = lg + F.dt_bias[n - 8]; const float sp = xx > 20.f ? xx : log1pf(expf(xx)); gA[(size_t)mm * 8 + (n - 8)] = -expf(F.a_log[n - 8]) * sp; } }
    }
}

constexpr int P2_LDS_PER_WAVE = 9216;
typedef short s16x8 __attribute__((ext_vector_type(8)));
__device__ __forceinline__ bf16x8 mk_frag(unsigned a, unsigned b, unsigned c, unsigned d) { u32x4 v = {a, b, c, d}; return __builtin_bit_cast(bf16x8, v); }
__device__ __forceinline__ f32x4 mfma16(bf16x8 a, bf16x8 b, f32x4 c) { return __builtin_amdgcn_mfma_f32_16x16x32_bf16(a, b, c, 0, 0, 0); }

struct ConvRows { const bf16* rb[4]; const float* rf[4]; int sel[4]; };
template <bool SAMPLE>
__device__ __forceinline__ void conv16(const ConvRows& R, int ch0, const float* w_short, float (&o)[16], float (&last)[16]) {
    float acc[16];
#pragma unroll
    for (int e = 0; e < 16; ++e) acc[e] = 0.f;
#pragma unroll
    for (int j = 0; j < 4; ++j) {
        float in[16];
        { u32x4 a = *(const u32x4*)(R.rb[j] + ch0), b = *(const u32x4*)(R.rb[j] + ch0 + 8);
          const unsigned msk = R.sel[j] == 1 ? 0xffffffffu : 0u; a.x &= msk; a.y &= msk; a.z &= msk; a.w &= msk; b.x &= msk; b.y &= msk; b.z &= msk; b.w &= msk;
          in[0] = bf_lo(a.x); in[1] = bf_hi(a.x); in[2] = bf_lo(a.y); in[3] = bf_hi(a.y); in[4] = bf_lo(a.z); in[5] = bf_hi(a.z); in[6] = bf_lo(a.w); in[7] = bf_hi(a.w);
          in[8] = bf_lo(b.x); in[9] = bf_hi(b.x); in[10] = bf_lo(b.y); in[11] = bf_hi(b.y); in[12] = bf_lo(b.z); in[13] = bf_hi(b.z); in[14] = bf_lo(b.w); in[15] = bf_hi(b.w); }
        if (SAMPLE && j < 3) {
#pragma unroll
            for (int q = 0; q < 4; ++q) { const f32x4 v = *(const f32x4*)(R.rf[j] + ch0 + 4 * q);
#pragma unroll
                for (int i = 0; i < 4; ++i) in[4 * q + i] = R.sel[j] == 2 ? v[i] : in[4 * q + i]; } }
#pragma unroll
        for (int q = 0; q < 4; ++q) { const f32x4 w = *(const f32x4*)(w_short + j * 1536 + ch0 + 4 * q);
            acc[4 * q] += w[0] * in[4 * q]; acc[4 * q + 1] += w[1] * in[4 * q + 1]; acc[4 * q + 2] += w[2] * in[4 * q + 2]; acc[4 * q + 3] += w[3] * in[4 * q + 3]; }
        if (j == 3) {
#pragma unroll
            for (int e = 0; e < 16; ++e) last[e] = in[e]; }
    }
#pragma unroll
    for (int e = 0; e < 16; ++e) o[e] = siluf(acc[e]);
}

#define PIN4(a, i) asm volatile("" : "+v"(a[i]), "+v"(a[i + 1]), "+v"(a[i + 2]), "+v"(a[i + 3]))
#define PIN16(a) do { PIN4(a, 0); PIN4(a, 4); PIN4(a, 8); PIN4(a, 12); } while (0)
template <bool SAMPLE>
__device__ __forceinline__ void p2_item(Frame& F, int item, LAS unsigned char* wl) {
    int lane_ = F.lane; asm volatile("" : "+v"(lane_));
    const int lane = lane_, c = lane & 15, part = lane >> 4;
    const bf16* QKVZ = (const bf16*)(F.ws + WS_QKVZ); const float* betaA = (const float*)(F.ws + WS_BETA); const float* gA = (const float*)(F.ws + WS_G);
    int h, m; bool real; ConvRows R; float* qkv_out = nullptr;
    if (!SAMPLE) { const int cc = item % NCH, bh = item / NCH, b = bh / NH; h = bh % NH; const int t = 16 * cc + c; m = b * SEQ + t; real = true;
#pragma unroll
        for (int j = 0; j < 4; ++j) { const int tt = t - 3 + j; R.sel[j] = tt >= 0 ? 1 : 0; R.rb[j] = QKVZ + (size_t)(tt >= 0 ? m - 3 + j : m) * 2048; R.rf[j] = nullptr; }
        if (t >= SEQ - 3) qkv_out = F.out + O_QKV_P + ((size_t)b * 3 + (t - (SEQ - 3))) * 1536;
    } else { const int sbh = item - NITEMS_P, sb = sbh / NH; h = sbh % NH; real = c < TS; const int cr = real ? c : 0; m = MP + sb * TS + cr;
#pragma unroll
        for (int j = 0; j < 4; ++j) { const int tt = cr - 3 + j; R.sel[j] = !real ? 0 : (tt >= 0 ? 1 : 2); R.rb[j] = QKVZ + (size_t)(MP + sb * TS + (tt >= 0 ? tt : 0)) * 2048; R.rf[j] = F.qkvst + ((size_t)sb * 3 + (tt < 0 ? tt + 3 : 0)) * 1536; }
        if (real && c >= 1) qkv_out = F.out + O_QKV_S + ((size_t)sb * 3 + (c - 1)) * 1536;
    }
    float qv[16], kv[16], vv[16], last[16];
    const int chq = 64 * h + 16 * part, chk = 512 + chq, chv = 1024 + chq;
    conv16<SAMPLE>(R, chq, F.w_short, qv, last);
    PIN16(qv); PIN16(last); asm volatile("" ::: "memory");
    if (qkv_out) {
#pragma unroll
        for (int q4 = 0; q4 < 4; ++q4) *(f32x4*)(qkv_out + chq + 4 * q4) = (f32x4){last[4 * q4], last[4 * q4 + 1], last[4 * q4 + 2], last[4 * q4 + 3]}; }
    asm volatile("" ::: "memory");
    conv16<SAMPLE>(R, chk, F.w_short, kv, last);
    PIN16(kv); PIN16(last); asm volatile("" ::: "memory");
    if (qkv_out) {
#pragma unroll
        for (int q4 = 0; q4 < 4; ++q4) *(f32x4*)(qkv_out + chk + 4 * q4) = (f32x4){last[4 * q4], last[4 * q4 + 1], last[4 * q4 + 2], last[4 * q4 + 3]}; }
    asm volatile("" ::: "memory");
    conv16<SAMPLE>(R, chv, F.w_short, vv, last);
    PIN16(vv); PIN16(last); asm volatile("" ::: "memory");
    if (qkv_out) {
#pragma unroll
        for (int q4 = 0; q4 < 4; ++q4) *(f32x4*)(qkv_out + chv + 4 * q4) = (f32x4){last[4 * q4], last[4 * q4 + 1], last[4 * q4 + 2], last[4 * q4 + 3]}; }
#if defined(P2_STOP) && P2_STOP == 1
    { float t_ = 0.f; for (int e = 0; e < 16; ++e) t_ += qv[e] + kv[e] + vv[e]; ((float*)(F.ws + WS_GL))[item * 64 + lane] = t_; return; }
#endif
    float sq = 0.f, sk = 0.f;
#pragma unroll
    for (int e = 0; e < 16; ++e) { sq += qv[e] * qv[e]; sk += kv[e] * kv[e]; }
    sq += __shfl_xor(sq, 16); sq += __shfl_xor(sq, 32); sk += __shfl_xor(sk, 16); sk += __shfl_xor(sk, 32);
    const float rq = __builtin_amdgcn_rsqf(sq + EPS) * 0.125f, rk = __builtin_amdgcn_rsqf(sk + EPS);
    float beta = real ? betaA[(size_t)m * 8 + h] : 0.f, g = real ? gA[(size_t)m * 8 + h] : 0.f;
    if (!real) {
#pragma unroll
        for (int e = 0; e < 16; ++e) { qv[e] = 0.f; kv[e] = 0.f; vv[e] = 0.f; } }
    float gc = g;
#pragma unroll
    for (int o = 1; o < 16; o <<= 1) { const float t = __shfl_up(gc, o, 16); if (c >= o) gc += t; }
    const float gcl = __shfl(gc, 15, 16), eg = __expf(gc), ekd = __expf(gcl - gc);
#pragma unroll
    for (int e = 0; e < 16; ++e) { qv[e] *= rq; kv[e] *= rk; }
    bf16x8 kf[2], qf[2];
#pragma unroll
    for (int ks = 0; ks < 2; ++ks) { kf[ks] = mk_frag(cvtpk(kv[8 * ks], kv[8 * ks + 1]), cvtpk(kv[8 * ks + 2], kv[8 * ks + 3]), cvtpk(kv[8 * ks + 4], kv[8 * ks + 5]), cvtpk(kv[8 * ks + 6], kv[8 * ks + 7]));
        qf[ks] = mk_frag(cvtpk(qv[8 * ks], qv[8 * ks + 1]), cvtpk(qv[8 * ks + 2], qv[8 * ks + 3]), cvtpk(qv[8 * ks + 4], qv[8 * ks + 5]), cvtpk(qv[8 * ks + 6], qv[8 * ks + 7])); }
    const f32x4 z4 = {0.f, 0.f, 0.f, 0.f};
    f32x4 Lr = mfma16(kf[0], kf[0], z4); Lr = mfma16(kf[1], kf[1], Lr);
    f32x4 Pr = mfma16(kf[0], qf[0], z4); Pr = mfma16(kf[1], qf[1], Pr);
    LAS float* Lt = (LAS float*)wl;
    LAS bf16* vbT = (LAS bf16*)(wl + 1024); LAS bf16* kbgT = (LAS bf16*)(wl + 3072); LAS bf16* kdT = (LAS bf16*)(wl + 5120); LAS bf16* qdL = (LAS bf16*)(wl + 7168);
    { f32x4 Lv; unsigned qk01, qk23; float qk[4];
#pragma unroll
      for (int r = 0; r < 4; ++r) { const int row = 4 * part + r; const float b_r = __shfl(beta, row), gc_r = __shfl(gc, row);
          Lv[r] = row > c ? b_r * Lr[r] * __expf(gc_r - gc) : 0.f;
          qk[r] = c >= row ? Pr[r] * __expf(gc - gc_r) : 0.f; }
      *(LAS f32x4*)(Lt + c * 16 + 4 * part) = Lv;
      qk01 = cvtpk(qk[0], qk[1]); qk23 = cvtpk(qk[2], qk[3]);
      unsigned char* rec = F.ws + WS_REC + (size_t)item * REC_BYTES;
      *(GAS u32x2*)(rec + REC_QK + lane * 8) = (u32x2){qk01, qk23}; }
#pragma unroll
    for (int e = 0; e < 16; ++e) { const int d = 16 * part + e; vbT[d * 16 + c] = (bf16)f2bf(vv[e] * beta); kbgT[d * 16 + c] = (bf16)f2bf(kv[e] * (beta * eg)); kdT[d * 16 + c] = (bf16)f2bf(kv[e] * ekd); }
    { u32x4 a, b; a.x = cvtpk(qv[0] * eg, qv[1] * eg); a.y = cvtpk(qv[2] * eg, qv[3] * eg); a.z = cvtpk(qv[4] * eg, qv[5] * eg); a.w = cvtpk(qv[6] * eg, qv[7] * eg);
      b.x = cvtpk(qv[8] * eg, qv[9] * eg); b.y = cvtpk(qv[10] * eg, qv[11] * eg); b.z = cvtpk(qv[12] * eg, qv[13] * eg); b.w = cvtpk(qv[14] * eg, qv[15] * eg);
      *(LAS u32x4*)(qdL + c * 64 + 16 * part) = a; *(LAS u32x4*)(qdL + c * 64 + 16 * part + 8) = b; }
    LDS_FENCE();
    float T[16];
#pragma unroll
    for (int j = 0; j < 16; ++j) T[j] = (j == c) ? 1.f : 0.f;
#pragma unroll
    for (int j = 14; j >= 0; --j) { float s = 0.f; asm volatile("" ::: "memory");
        const f32x4 l0 = *(const LAS f32x4*)(Lt + j * 16), l1 = *(const LAS f32x4*)(Lt + j * 16 + 4), l2 = *(const LAS f32x4*)(Lt + j * 16 + 8), l3 = *(const LAS f32x4*)(Lt + j * 16 + 12);
        const float lj[16] = {l0[0], l0[1], l0[2], l0[3], l1[0], l1[1], l1[2], l1[3], l2[0], l2[1], l2[2], l2[3], l3[0], l3[1], l3[2], l3[3]};
#pragma unroll
        for (int k = j + 1; k < 16; ++k) s += T[k] * lj[k];
        T[j] = (j < c) ? -s : T[j]; }
    float t4[4];
#pragma unroll
    for (int jj = 0; jj < 4; ++jj) t4[jj] = part == 0 ? T[jj] : part == 1 ? T[4 + jj] : part == 2 ? T[8 + jj] : T[12 + jj];
    const bf16x8 Tf = mk_frag(cvtpk(t4[0], t4[1]), cvtpk(t4[2], t4[3]), 0u, 0u);
    unsigned char* rec = F.ws + WS_REC + (size_t)item * REC_BYTES;
#pragma unroll
    for (int nt = 0; nt < 4; ++nt) { const u32x2 bv = *(const LAS u32x2*)(vbT + (16 * nt + c) * 16 + 4 * part);
        const f32x4 u = mfma16(Tf, mk_frag(bv.x, bv.y, 0u, 0u), z4);
        *(GAS f32x4*)(rec + REC_U + (nt * 64 + lane) * 16) = u; }
    { unsigned wp[4][2];
#pragma unroll
      for (int dt = 0; dt < 4; ++dt) { const u32x2 av = *(const LAS u32x2*)(kbgT + (16 * dt + c) * 16 + 4 * part);
          const f32x4 w = mfma16(mk_frag(av.x, av.y, 0u, 0u), Tf, z4); wp[dt][0] = cvtpk(w[0], w[1]); wp[dt][1] = cvtpk(w[2], w[3]); }
      *(GAS u32x4*)(rec + REC_W + (0 * 64 + lane) * 16) = (u32x4){wp[0][0], wp[0][1], wp[1][0], wp[1][1]};
      *(GAS u32x4*)(rec + REC_W + (1 * 64 + lane) * 16) = (u32x4){wp[2][0], wp[2][1], wp[3][0], wp[3][1]}; }
#pragma unroll
    for (int ks = 0; ks < 2; ++ks) { const u32x2 lo = *(const LAS u32x2*)(qdL + c * 64 + 32 * ks + 4 * part), hi = *(const LAS u32x2*)(qdL + c * 64 + 32 * ks + 16 + 4 * part);
        *(GAS u32x4*)(rec + REC_QD + (ks * 64 + lane) * 16) = (u32x4){lo.x, lo.y, hi.x, hi.y}; }
#pragma unroll
    for (int t = 0; t < 4; ++t) { const u32x2 kd = *(const LAS u32x2*)(kdT + (16 * t + c) * 16 + 4 * part); *(GAS u32x2*)(rec + REC_KD + (t * 64 + lane) * 8) = kd; }
    if (lane == 0) ((float*)(F.ws + WS_GL))[item] = __expf(gcl);
    LDS_FENCE();
}
__device__ __forceinline__ void p2_prep(Frame& F) {
    LAS unsigned char* wl = F.lds + RING_OFF + F.wave * P2_LDS_PER_WAVE;
    const int gw = F.bid * NWAVES + F.wave, NGW = F.G * NWAVES;
    for (int it = gw; it < NITEMS_P; it += NGW) p2_item<false>(F, it, wl);
    for (int it = NITEMS_P + gw; it < NITEMS; it += NGW) p2_item<true>(F, it, wl);
}

struct StepOps { bf16x8 w0, w1, qd0, qd1; u32x2 kd[4]; u32x2 qk; f32x4 u; float gl; };
__device__ __forceinline__ bf16x8 pack2(const f32x4& a, const f32x4& b) { return mk_frag(cvtpk(a[0], a[1]), cvtpk(a[2], a[3]), cvtpk(b[0], b[1]), cvtpk(b[2], b[3])); }
__device__ __forceinline__ f32x4 scan_step(f32x4 (&S)[4], const StepOps& P) {
    const f32x4 z4 = {0.f, 0.f, 0.f, 0.f};
    const bf16x8 bs0 = pack2(S[0], S[1]), bs1 = pack2(S[2], S[3]);
    f32x4 ws = mfma16(P.w0, bs0, z4); ws = mfma16(P.w1, bs1, ws);
    f32x4 o = mfma16(P.qd0, bs0, z4); o = mfma16(P.qd1, bs1, o);
    const f32x4 vn = P.u - ws;
    const bf16x8 bv = mk_frag(cvtpk(vn[0], vn[1]), cvtpk(vn[2], vn[3]), 0u, 0u);
    o = mfma16(mk_frag(P.qk.x, P.qk.y, 0u, 0u), bv, o);
#pragma unroll
    for (int t = 0; t < 4; ++t) S[t] = mfma16(mk_frag(P.kd[t].x, P.kd[t].y, 0u, 0u), bv, S[t] * P.gl);
    return o;
}
constexpr int SC_BLK = 4 * REC_BYTES;
constexpr int SC_OB_STRIDE = 68;
constexpr int SC_OB_BYTES = 64 * SC_OB_STRIDE * 4;
constexpr int SC_OB_OFF = 2 * SC_BLK;
static_assert(SC_OB_OFF + 2 * SC_OB_BYTES <= RING_BYTES, "scan LDS");
__device__ __forceinline__ void scan_post_rows(Frame& F, const LAS float* ob, int m0, int h, int t  ) {
    const int row = 16 * (t >> 6) + (t & 15), qt = (t >> 4) & 3; const LAS float* p = ob + row * SC_OB_STRIDE + 16 * qt;
    float v[16]; float ss = 0.f;
#pragma unroll
    for (int i = 0; i < 4; ++i) { const f32x4 x = *(const LAS f32x4*)(p + 4 * i); v[4 * i] = x[0]; v[4 * i + 1] = x[1]; v[4 * i + 2] = x[2]; v[4 * i + 3] = x[3]; ss += (x[0] * x[0] + x[1] * x[1]) + (x[2] * x[2] + x[3] * x[3]); }
    ss += __shfl_xor(ss, 16); ss += __shfl_xor(ss, 32);
    const float rs = __builtin_amdgcn_rsqf(ss * (1.0f / 64.0f) + EPS);
    const size_t m = (size_t)(m0 + row);
    const bf16* zr = (const bf16*)(F.ws + WS_QKVZ) + m * 2048 + 1536 + 64 * h + 16 * qt;
    const u32x4 za = *(const u32x4*)zr, zb = *(const u32x4*)(zr + 8);
    const float z[16] = {bf_lo(za.x), bf_hi(za.x), bf_lo(za.y), bf_hi(za.y), bf_lo(za.z), bf_hi(za.z), bf_lo(za.w), bf_hi(za.w), bf_lo(zb.x), bf_hi(zb.x), bf_lo(zb.y), bf_hi(zb.y), bf_lo(zb.z), bf_hi(zb.z), bf_lo(zb.w), bf_hi(zb.w)};
    float o[16];
#pragma unroll
    for (int i = 0; i < 16; ++i) o[i] = v[i] * rs * F.g_o[16 * qt + i] * siluf(z[i]);
    bf16* dst = (bf16*)(F.ws + WS_AMIX) + m * D + 64 * h + 16 * qt;
    *(GAS u32x4*)dst = (u32x4){cvtpk(o[0], o[1]), cvtpk(o[2], o[3]), cvtpk(o[4], o[5]), cvtpk(o[6], o[7])};
    *(GAS u32x4*)(dst + 8) = (u32x4){cvtpk(o[8], o[9]), cvtpk(o[10], o[11]), cvtpk(o[12], o[13]), cvtpk(o[14], o[15])};
}
__device__ __forceinline__ void scan_prompt(Frame& F, int bh) {
    const int b = bh / NH, h = bh % NH, lane = F.lane, w = F.wave;
    const unsigned char* recs = F.ws + WS_REC + (size_t)bh * NCH * REC_BYTES; const float* glA = (const float*)(F.ws + WS_GL) + bh * NCH;
    LAS unsigned char* L = F.lds + RING_OFF;
    f32x4 S[4];
#pragma unroll
    for (int t = 0; t < 4; ++t) S[t] = (f32x4){0.f, 0.f, 0.f, 0.f};
    constexpr int NBLK = NCH / 4;
    for (int nb = 0; nb <= NBLK; ++nb) {
        if (w >= 4) {
            const int t = F.tid - 256;
            if (nb == 0) {
#pragma unroll
                for (int i = 0; i < 11; ++i) { const int idx = i * 256 + t; if (idx < SC_BLK / 16) *(LAS u32x4*)(L + idx * 16) = *(const u32x4*)(recs + (size_t)idx * 16); }
            }
        }
        __syncthreads();
        if (w < 4) {
            if (nb < NBLK) {
                const LAS unsigned char* bp = L + (nb & 1) * SC_BLK; LAS float* ob = (LAS float*)(L + SC_OB_OFF + (nb & 1) * SC_OB_BYTES);
                const f32x4 gl4 = *(const f32x4*)(glA + 4 * nb);
#pragma unroll
                for (int k = 0; k < 4; ++k) { const LAS unsigned char* r = bp + k * REC_BYTES; StepOps P;
                    P.w0 = *(const LAS bf16x8*)(r + REC_W + lane * 16); P.w1 = *(const LAS bf16x8*)(r + REC_W + (64 + lane) * 16);
                    P.qd0 = *(const LAS bf16x8*)(r + REC_QD + lane * 16); P.qd1 = *(const LAS bf16x8*)(r + REC_QD + (64 + lane) * 16);
#pragma unroll
                    for (int t = 0; t < 4; ++t) P.kd[t] = *(const LAS u32x2*)(r + REC_KD + (t * 64 + lane) * 8);
                    P.qk = *(const LAS u32x2*)(r + REC_QK + lane * 8); P.u = *(const LAS f32x4*)(r + REC_U + (w * 64 + lane) * 16); P.gl = gl4[k];
                    const f32x4 o = scan_step(S, P);
#pragma unroll
                    for (int rr = 0; rr < 4; ++rr) ob[(16 * k + 4 * (lane >> 4) + rr) * SC_OB_STRIDE + 16 * w + (lane & 15)] = o[rr]; }
            }
        } else {
            const int t = F.tid - 256;
            if (nb + 1 < NBLK) { const unsigned char* src = recs + (size_t)(nb + 1) * SC_BLK; LAS unsigned char* dst = L + ((nb + 1) & 1) * SC_BLK;
#pragma unroll
                for (int i = 0; i < 11; ++i) { const int idx = i * 256 + t; if (idx < SC_BLK / 16) *(LAS u32x4*)(dst + idx * 16) = *(const u32x4*)(src + (size_t)idx * 16); } }
            if (nb >= 1) scan_post_rows(F, (const LAS float*)(L + SC_OB_OFF + ((nb - 1) & 1) * SC_OB_BYTES), b * SEQ + 64 * (nb - 1), h, t);
        }
    }
    if (w < 4) {
        float* dst = F.out + O_SSM_P + (size_t)bh * HD * HD;
#pragma unroll
        for (int t = 0; t < 4; ++t)
#pragma unroll
            for (int rr = 0; rr < 4; ++rr) dst[(16 * t + 4 * (lane >> 4) + rr) * HD + 16 * w + (lane & 15)] = S[t][rr];
    }
    __syncthreads();
}
__device__ __forceinline__ void scan_sample(Frame& F, int sbh) {
    const int sb = sbh / NH, h = sbh % NH, lane = F.lane, q = lane >> 4, dl = lane & 15;
    const unsigned char* r = F.ws + WS_REC + (size_t)(NITEMS_P + sbh) * REC_BYTES; const float gl = ((const float*)(F.ws + WS_GL))[NITEMS_P + sbh];
    StepOps P;
    P.w0 = *(const bf16x8*)(r + REC_W + lane * 16); P.w1 = *(const bf16x8*)(r + REC_W + (64 + lane) * 16);
    P.qd0 = *(const bf16x8*)(r + REC_QD + lane * 16); P.qd1 = *(const bf16x8*)(r + REC_QD + (64 + lane) * 16);
#pragma unroll
    for (int t = 0; t < 4; ++t) P.kd[t] = *(const u32x2*)(r + REC_KD + (t * 64 + lane) * 8);
    P.qk = *(const u32x2*)(r + REC_QK + lane * 8); P.gl = gl;
    const float* S0 = F.ssm + (size_t)sbh * HD * HD; float* S1 = F.out + O_SSM_S + (size_t)sbh * HD * HD;
    f32x4 O[4]; float ss[4] = {0.f, 0.f, 0.f, 0.f};
#pragma unroll
    for (int s = 0; s < 4; ++s) { f32x4 S[4];
#pragma unroll
        for (int t = 0; t < 4; ++t)
#pragma unroll
            for (int rr = 0; rr < 4; ++rr) S[t][rr] = S0[(16 * t + 4 * q + rr) * HD + 16 * s + dl];
        P.u = *(const f32x4*)(r + REC_U + (s * 64 + lane) * 16);
        O[s] = scan_step(S, P);
#pragma unroll
        for (int t = 0; t < 4; ++t)
#pragma unroll
            for (int rr = 0; rr < 4; ++rr) S1[(16 * t + 4 * q + rr) * HD + 16 * s + dl] = S[t][rr];
#pragma unroll
        for (int rr = 0; rr < 4; ++rr) ss[rr] += O[s][rr] * O[s][rr]; }
#pragma unroll
    for (int rr = 0; rr < 4; ++rr) { float v = ss[rr]; v += __shfl_xor(v, 1); v += __shfl_xor(v, 2); v += __shfl_xor(v, 4); v += __shfl_xor(v, 8); ss[rr] = __builtin_amdgcn_rsqf(v * (1.0f / 64.0f) + EPS); }
    if (q == 0) {
#pragma unroll
        for (int rr = 0; rr < 4; ++rr) { const size_t m = (size_t)(MP + sb * TS + rr); const bf16* zr = (const bf16*)(F.ws + WS_QKVZ) + m * 2048 + 1536 + 64 * h; bf16* dst = (bf16*)(F.ws + WS_AMIX) + m * D + 64 * h;
#pragma unroll
            for (int s = 0; s < 4; ++s) { const int d = 16 * s + dl; const float z = __uint_as_float((unsigned)zr[d] << 16); dst[d] = (bf16)f2bf(O[s][rr] * ss[rr] * F.g_o[d] * siluf(z)); } }
    }
}

constexpr int CF_ROWS = 94, CF_LDS_PER_WAVE = CF_ROWS * 128;
__device__ __forceinline__ void conf_finish(Frame& F, float cv, int ch, size_t m) {
    float s = cv;
#pragma unroll
    for (int o = 1; o < 64; o <<= 1) s += __shfl_xor(s, o);
    const float mu = s * (1.0f / 64.0f), dlt = cv - mu; float q = dlt * dlt;
#pragma unroll
    for (int o = 1; o < 64; o <<= 1) q += __shfl_xor(q, o);
    const float y = dlt * __builtin_amdgcn_rsqf(q * (1.0f / 64.0f) + EPS) * F.g_cln[ch] + F.b_cln[ch];
    ((bf16*)(F.ws + WS_AMIX))[m * D + 512 + ch] = (bf16)f2bf(siluf(y));
}
__device__ __forceinline__ void conf_item_prompt(Frame& F, int item, LAS unsigned char* wl) {
    const int g = item & 7, tile = (item >> 3) & 31, b = item >> 8, lane = F.lane, ch = 64 * g + lane, t0 = 64 * tile;
    const bf16* GLU = (const bf16*)(F.ws + WS_GLU);
#pragma unroll
    for (int i = 0; i < 12; ++i) { const int rr = 8 * i + (lane >> 3); const int t = t0 - 30 + rr; u32x4 v = {0u, 0u, 0u, 0u};
        if (rr < CF_ROWS && t >= 0) v = *(const u32x4*)(GLU + (size_t)(b * SEQ + t) * 512 + 64 * g + 8 * (lane & 7));
        if (rr < CF_ROWS) *(LAS u32x4*)(wl + rr * 128 + 16 * (lane & 7)) = v; }
    LDS_FENCE();
    float w[31];
#pragma unroll
    for (int j = 0; j < 31; ++j) w[j] = F.w_dw[j * CCH + ch];
    const float bias = F.b_dw[ch];
    const LAS bf16* col = (const LAS bf16*)wl + lane;
    for (int tb = 0; tb < 8; ++tb) {
        float in[38];
#pragma unroll
        for (int i = 0; i < 38; ++i) in[i] = __uint_as_float((unsigned)col[(8 * tb + i) * 64] << 16);
        if (tile == 31 && tb >= 4) {
#pragma unroll
            for (int e = 0; e < 8; ++e) { const int tl = 8 * tb + e; if (tl >= 34) F.out[O_CONF_P + ((size_t)b * 30 + (tl - 34)) * CCH + ch] = in[30 + e]; } }
#pragma unroll
        for (int e = 0; e < 8; ++e) { float a = bias;
#pragma unroll
            for (int j = 0; j < 31; ++j) a += w[j] * in[e + j];
            conf_finish(F, a, ch, (size_t)(b * SEQ + t0 + 8 * tb + e)); }
    }
    LDS_FENCE();
}
__device__ __forceinline__ void conf_item_sample(Frame& F, int item) {
    const int g = item & 7, sb = item >> 3, lane = F.lane, ch = 64 * g + lane;
    float in[34];
#pragma unroll
    for (int j = 0; j < 30; ++j) in[j] = F.confst[((size_t)sb * 30 + j) * CCH + ch];
#pragma unroll
    for (int e = 0; e < 4; ++e) in[30 + e] = __uint_as_float((unsigned)((const bf16*)(F.ws + WS_GLU))[(size_t)(MP + sb * TS + e) * 512 + ch] << 16);
#pragma unroll
    for (int j = 0; j < 30; ++j) F.out[O_CONF_S + ((size_t)sb * 30 + j) * CCH + ch] = in[4 + j];
    const float bias = F.b_dw[ch];
    float a[4] = {bias, bias, bias, bias};
#pragma unroll
    for (int j = 0; j < 31; ++j) { const float w = F.w_dw[j * CCH + ch];
#pragma unroll
        for (int e = 0; e < 4; ++e) a[e] += w * in[e + j]; }
#pragma unroll
    for (int e = 0; e < 4; ++e) conf_finish(F, a[e], ch, (size_t)(MP + sb * TS + e));
}
#ifndef DBG_NOPS
#define DBG_NOPS 0
#endif
#ifndef DBG_NOSS
#define DBG_NOSS 0
#endif
__device__ __forceinline__ void p3_mixer(Frame& F) {
    constexpr int NSCAN = NB * NH;
#if DBG_NOPS || DBG_NOSS
    { const int nthr = F.G * NWAVES * 64, t0 = F.bid * (NWAVES * 64) + F.tid; bf16* A = (bf16*)(F.ws + WS_AMIX);
      if (DBG_NOPS) { for (int i = t0; i < MP * 512; i += nthr) A[(size_t)(i >> 9) * D + (i & 511)] = 0;
                      for (int i = t0; i < NB * NH * HD * HD; i += nthr) F.out[O_SSM_P + i] = 0.f; }
      if (DBG_NOSS) { for (int i = t0; i < MS * 512; i += nthr) A[(size_t)(MP + (i >> 9)) * D + (i & 511)] = 0;
                      for (int i = t0; i < NSB * NH * HD * HD; i += nthr) F.out[O_SSM_S + i] = 0.f; } }
#endif
#if !DBG_NOPS
    if (F.bid < NSCAN) scan_prompt(F, F.bid);
#endif
    if (F.bid < NSCAN) return;
    const int gw = (F.bid - NSCAN) * NWAVES + F.wave, NGW = (F.G - NSCAN) * NWAVES;
    constexpr int N_SS = NSB * NH, N_CS = NSB * 8, N_CP = NB * 32 * 8;
    LAS unsigned char* wl = F.lds + RING_OFF + F.wave * CF_LDS_PER_WAVE;
    for (int it = gw; it < N_SS + N_CS + N_CP; it += NGW) {
        if (it < N_SS) { if (!DBG_NOSS) scan_sample(F, it); }
        else if (it < N_SS + N_CS) conf_item_sample(F, it - N_SS);
        else conf_item_prompt(F, it - N_SS - N_CS, wl);
    }
}

__device__ __forceinline__ void p9_final(Frame& F) {
    const float* rss3 = (const float*)(F.ws + WS_CTL) + CW_RSS3;
    const int nthr = F.G * NWAVES * 64, t0 = F.bid * (NWAVES * 64) + F.tid;
    for (int i = t0; i < M * D / 4; i += nthr) { const int row = i >> 8, c4 = (i & 255) * 4; const float rs = pg8::rstd_of(rss3[row]);
        f32x4 v = *(const f32x4*)(F.out + (size_t)i * 4); const f32x4 g = *(const f32x4*)(F.g_final + c4);
        v = v * rs * g; *(f32x4*)(F.out + (size_t)i * 4) = v; }
}

#ifndef MK_PER_PHASE
#define MK_PER_PHASE 1
#endif
#ifndef MK_BAR
#define MK_BAR 1
#endif
constexpr int N_PHASES = 10;
struct Args { const float* in[25]; float* out; unsigned char* ws; int ph_lo, ph_hi; };
static_assert(sizeof(Args) == 27 * 8 + 8, "Args has no padding");
__device__ __forceinline__ const float* late_ptr(const Args& a, int k) { asm volatile("" : "+s"(k)); return a.in[k]; }
#define LATE(k) late_ptr(args, k)
__global__ void __launch_bounds__(NWAVES * 64, 2) hybrid_fwd(Args args) {
    extern __shared__ __attribute__((aligned(16))) unsigned char lds_raw[];
    Frame F;
    F.lds = (LAS unsigned char*)lds_raw;
    F.tid = threadIdx.x; F.lane = F.tid & 63; F.wave = __builtin_amdgcn_readfirstlane(F.tid >> 6); F.G = gridDim.x; F.bid = blockIdx.x;
    F.out = args.out; F.ws = args.ws;
    unsigned char* ws = args.ws;
    float* ctlf = (float*)(ws + WS_CTL);
    for (int u = F.tid; u < (LDS_BYTES - LDSCTL_OFF) / 4; u += NWAVES * 64) ((LAS unsigned*)(F.lds + LDSCTL_OFF))[u] = 0u;
    __syncthreads();
#if !MK_PER_PHASE && MK_BAR == 1
    XcdBarrier bar = xcd_barrier_post((unsigned*)(ws + WS_CTL) + CW_BAR, (volatile LAS unsigned*)(F.lds + MISC_OFF) + 8);
#define GRID_BAR() xcd_barrier(bar)
#elif !MK_PER_PHASE
#define GRID_BAR() cg::this_grid().sync()
#else
#define GRID_BAR() do {} while (0)
#endif
    const int lo = args.ph_lo, hi = args.ph_hi;
#ifndef PHMASK
#define PHMASK 0x3ff
#endif
#define IN(k) (lo <= (k) && (k) < hi && ((PHMASK >> (k)) & 1))
#define FRESH() do { int t_ = threadIdx.x; asm volatile("" : "+v"(t_)); F.tid = t_; F.lane = t_ & 63; F.wave = __builtin_amdgcn_readfirstlane(t_ >> 6); } while (0)
#define SEAM(k) do { if (IN(k) && IN((k) + 1)) GRID_BAR(); } while (0)
    bf16* const XB = (bf16*)(ws + WS_XB); bf16* const QKVZ = (bf16*)(ws + WS_QKVZ); bf16* const GLU = (bf16*)(ws + WS_GLU); bf16* const AMIX = (bf16*)(ws + WS_AMIX);
    bf16* const X1B = (bf16*)(ws + WS_X1B); bf16* const HB = (bf16*)(ws + WS_HB); bf16* const X2B = (bf16*)(ws + WS_X2B); bf16* const PLEB = (bf16*)(ws + WS_PLE); bf16* const PB = (bf16*)(ws + WS_PB);
    float* const rss0 = (float*)(ws + WS_RSS0); float* const rss1 = ctlf + CW_RSS1; float* const rss2 = ctlf + CW_RSS2; float* const rss3 = ctlf + CW_RSS3;

    if (IN(0)) { FRESH(); F.xp = LATE(0); F.xs = LATE(1); F.pp = LATE(5); F.psm = LATE(6); F.g_mix = LATE(7); F.w_in = LATE(8); F.a_log = LATE(10); F.dt_bias = LATE(11); F.w_out = LATE(17); F.g_mlp = LATE(18);
        F.w_up = LATE(19); F.w_down = LATE(20); F.w_ple = LATE(21); F.g_ple = LATE(22); F.w_gate = LATE(23); p0_prologue(F); } SEAM(0);
    if (IN(1)) {
        pg8::Gemm g{XB, (const bf16*)(ws + WS_WIN), M, NIN, D}; pg8::StaticOrder S; S.init(M, NIN, F.G, F.bid);
        pg8::EpiIn E{QKVZ, GLU, rss0};
        pg8::gemm_phase<pg8::EpiIn, pg8::StaticOrder, true, true>(F.lds + RING_OFF, g, S, E);
    } SEAM(1);
    if (IN(2)) { FRESH(); F.qkvst = LATE(3); F.w_short = LATE(9); p2_prep(F); } SEAM(2);
    if (IN(3)) { FRESH(); F.ssm = LATE(2); F.confst = LATE(4); F.g_o = LATE(12); F.w_dw = LATE(13); F.b_dw = LATE(14); F.g_cln = LATE(15); F.b_cln = LATE(16); p3_mixer(F); } SEAM(3);
    if (IN(4)) {
        pg8::Gemm g{AMIX, (const bf16*)(ws + WS_WOUT), M, D, D}; pg8::StaticOrder S; S.init(M, D, F.G, F.bid);
        pg8::EpiRes<0> E{LATE(0), LATE(1), F.out, X1B, rss1, nullptr, nullptr};
        pg8::gemm_phase<pg8::EpiRes<0>, pg8::StaticOrder, true, true>(F.lds + RING_OFF, g, S, E);
    } SEAM(4);
    if (IN(5)) {
        pg8::Gemm g{X1B, (const bf16*)(ws + WS_WUP), M, FF, D}; pg8::StaticOrder S; S.init(M, FF, F.G, F.bid);
        pg8::EpiBf<1> E{HB, FF, rss1};
        pg8::gemm_phase<pg8::EpiBf<1>, pg8::StaticOrder, true, true>(F.lds + RING_OFF, g, S, E);
    } SEAM(5);
    if (IN(6)) {
        pg8::Gemm g{HB, (const bf16*)(ws + WS_WDOWN), M, D, FF}; pg8::StaticOrder S; S.init(M, D, F.G, F.bid);
        pg8::EpiRes<1> E{nullptr, nullptr, F.out, X2B, rss2, nullptr, nullptr};
        pg8::gemm_phase<pg8::EpiRes<1>, pg8::StaticOrder, true, true>(F.lds + RING_OFF, g, S, E);
    } SEAM(6);
    if (IN(7)) {
        pg8::Gemm g{PB, (const bf16*)(ws + WS_WPLE), M, D, DPLE}; pg8::StaticOrder S; S.init(M, D, F.G, F.bid);
        pg8::EpiBf<0> E{PLEB, D, nullptr};
        pg8::gemm_phase<pg8::EpiBf<0>, pg8::StaticOrder, true, true>(F.lds + RING_OFF, g, S, E);
    } SEAM(7);
    if (IN(8)) {
        pg8::Gemm g{X2B, (const bf16*)(ws + WS_WGATE), M, D, D}; pg8::StaticOrder S; S.init(M, D, F.G, F.bid);
        pg8::EpiRes<2> E{nullptr, nullptr, F.out, nullptr, rss3, rss2, PLEB};
        pg8::gemm_phase<pg8::EpiRes<2>, pg8::StaticOrder, true, true>(F.lds + RING_OFF, g, S, E);
    } SEAM(8);
    if (IN(9)) { FRESH(); F.g_final = LATE(24); p9_final(F); }
#undef IN
#undef SEAM
}

extern "C" void kernel_launch(void* const* d_in, const int* in_sizes, int n_in, void* d_out, int out_size, void* d_ws, size_t ws_size, hipStream_t stream) {
    static int grid = 0;
    if (grid == 0) {
        if (n_in != 25 || out_size != (int)O_END || ws_size < WS_END) { fprintf(stderr, "kernel_launch: unexpected shapes: n_in %d out %d ws %zu\n", n_in, out_size, ws_size); grid = -1; return; }
        int dev = 0, cus = 0, per_cu = 0;
        if (hipGetDevice(&dev) != hipSuccess || hipDeviceGetAttribute(&cus, hipDeviceAttributeMultiprocessorCount, dev) != hipSuccess) { grid = -1; return; }
        if (hipFuncSetAttribute((const void*)hybrid_fwd, hipFuncAttributeMaxDynamicSharedMemorySize, LDS_BYTES) != hipSuccess) { fprintf(stderr, "kernel_launch: hipFuncSetAttribute failed\n"); grid = -1; return; }
        if (hipOccupancyMaxActiveBlocksPerMultiprocessor(&per_cu, (const void*)hybrid_fwd, NWAVES * 64, LDS_BYTES) != hipSuccess || per_cu < 1) { fprintf(stderr, "kernel_launch: occupancy query says %d blocks per CU\n", per_cu); }
        (void)hipGetLastError();
        grid = cus;
    }
    if (grid < 0) return;
    (void)hipMemsetAsync((char*)d_ws + WS_CTL, 0, CTL_ZERO_BYTES, stream);
    Args a{};
    for (int i = 0; i < 25; ++i) a.in[i] = (const float*)d_in[i];
    a.out = (float*)d_out; a.ws = (unsigned char*)d_ws;
#if MK_PER_PHASE
    for (int p = 0; p < N_PHASES; ++p) { a.ph_lo = p; a.ph_hi = p + 1; hipLaunchKernelGGL(hybrid_fwd, dim3(grid), dim3(NWAVES * 64), LDS_BYTES, stream, a); }
#else
    a.ph_lo = 0; a.ph_hi = N_PHASES;
    void* kargs[] = {&a};
    hipError_t e = hipLaunchCooperativeKernel((const void*)hybrid_fwd, dim3(grid), dim3(NWAVES * 64), kargs, LDS_BYTES, stream);
    if (e != hipSuccess) fprintf(stderr, "kernel_launch: cooperative launch failed: %s (grid %d)\n", hipGetErrorString(e), grid);
#endif
}
```
